# Optimizing an MI355X kernel written in HIP

```python
import jax, jax.numpy as jnp
from jax import lax
import numpy as np

D_MODEL = 1024
BATCH = 4
SEQ = 4096
DEPTH = 1

CHUNK = 128
A_GROUPS = 8
A_WIDTH = 1024
A_GROUP_DIM = A_WIDTH // A_GROUPS
N_HEADS = 8
N_KV_HEADS = 2
HEAD_DIM = 128
IDX_HEADS = 8
IDX_DIM = 64
TOPK_MAX = 256
Q_BLOCK = 128
ROPE_THETA = 500000.0
ROT_DIM = HEAD_DIM // 4
IDX_ROT_DIM = IDX_DIM // 4
D_FF = -(-8 * D_MODEL // (3 * 256)) * 256
EPS = 1e-6
NEG_INF = -1e30

IN_SIZES = (A_WIDTH, A_WIDTH, N_HEADS * HEAD_DIM, N_KV_HEADS * HEAD_DIM,
            N_KV_HEADS * HEAD_DIM, IDX_HEADS * IDX_DIM, IDX_DIM, IDX_HEADS,
            D_MODEL, D_MODEL)
IN_COLS = sum(IN_SIZES)

kernel_name = "hybrid_gated_gmlp_dsa_block"


def rms_norm(x, g):
    xf = x.astype(jnp.float32)
    y = xf * lax.rsqrt(jnp.mean(xf * xf, axis=-1, keepdims=True) + EPS)
    return (y * g.astype(jnp.float32)).astype(x.dtype)


def layer_norm(x, g, b):
    xf = x.astype(jnp.float32)
    mu = jnp.mean(xf, axis=-1, keepdims=True)
    var = jnp.mean(jnp.square(xf - mu), axis=-1, keepdims=True)
    y = (xf - mu) * lax.rsqrt(var + EPS)
    return (y * g.astype(jnp.float32) + b.astype(jnp.float32)).astype(x.dtype)


def partial_rope(x, pos, rot_dim):
    inv_freq = ROPE_THETA ** (-jnp.arange(0, rot_dim, 2, dtype=jnp.float32) / rot_dim)
    ang = pos.astype(jnp.float32)[..., None] * inv_freq
    cos = jnp.cos(ang)[:, :, None, :]
    sin = jnp.sin(ang)[:, :, None, :]
    xr = x[..., :rot_dim].astype(jnp.float32)
    x1, x2 = xr[..., : rot_dim // 2], xr[..., rot_dim // 2:]
    rot = jnp.concatenate([x1 * cos - x2 * sin, x2 * cos + x1 * sin], axis=-1)
    return jnp.concatenate([rot.astype(x.dtype), x[..., rot_dim:]], axis=-1)


def chunked_gmlp(u, v, w_s, b_s, ln_g, ln_b):
    bsz, s, _ = u.shape
    n = s // CHUNK
    v = layer_norm(v, ln_g, ln_b).reshape(bsz, n, CHUNK, A_GROUPS, A_GROUP_DIM)
    mask = jnp.tril(jnp.ones((CHUNK, CHUNK), dtype=w_s.dtype))
    mixed = jnp.einsum('gts,bnsgc->bntgc', w_s * mask, v) + b_s.T[None, None, :, :, None]
    return u * mixed.reshape(bsz, s, A_WIDTH)


def dsa_attention(q, k, v, qi, ki, wi):
    bsz, s = q.shape[0], q.shape[1]
    top_k = min(TOPK_MAX, s // 4)
    n_blocks = s // Q_BLOCK
    key_pos = jnp.arange(s)
    ki32 = ki.astype(jnp.float32)
    gather = jax.vmap(lambda kk, ii: kk[ii])

    def block(i):
        start = i * Q_BLOCK
        qb = lax.dynamic_slice_in_dim(q, start, Q_BLOCK, axis=1)
        qib = lax.dynamic_slice_in_dim(qi, start, Q_BLOCK, axis=1).astype(jnp.float32)
        wib = lax.dynamic_slice_in_dim(wi, start, Q_BLOCK, axis=1).astype(jnp.float32)
        qpos = start + jnp.arange(Q_BLOCK)
        causal = key_pos[None, :] <= qpos[:, None]
        logits = jnp.einsum('bthd,bsd->bths', qib, ki32) * (IDX_DIM ** -0.5)
        score = jnp.einsum('bth,bths->bts', wib * (IDX_HEADS ** -0.5), jax.nn.relu(logits))
        score = jnp.where(causal[None], score, -jnp.inf)
        sel_score, sel_idx = lax.top_k(score, top_k)
        valid = jnp.isfinite(sel_score)
        k_sel = gather(k, sel_idx).astype(jnp.float32)
        v_sel = gather(v, sel_idx).astype(jnp.float32)
        qg = qb.reshape(bsz, Q_BLOCK, N_KV_HEADS, N_HEADS // N_KV_HEADS, HEAD_DIM)
        att = jnp.einsum('btgrd,btkgd->btgrk', qg.astype(jnp.float32), k_sel) * (HEAD_DIM ** -0.5)
        att = jnp.where(valid[:, :, None, None, :], att, NEG_INF)
        p = jax.nn.softmax(att, axis=-1)
        o = jnp.einsum('btgrk,btkgd->btgrd', p, v_sel).astype(q.dtype)
        return o.reshape(bsz, Q_BLOCK, N_HEADS * HEAD_DIM)

    out = lax.map(block, jnp.arange(n_blocks))
    return out.transpose(1, 0, 2, 3).reshape(bsz, s, N_HEADS * HEAD_DIM)


def hybrid_layer(x, c, positions, w_ada, b_ada, norm1_g, w_in, gmlp_ln_g, gmlp_ln_b,
                 gmlp_w_s, gmlp_b_s, idx_k_ln_g, idx_k_ln_b, w_proj_a, w_proj_b, w_out,
                 norm2_g, w_ffn_in, w_ffn_out):
    bsz, s, _ = x.shape
    mod = jax.nn.silu(c) @ w_ada + b_ada
    shift1, scale1, gate1, shift2, scale2, gate2 = [m[:, None, :] for m in jnp.split(mod, 6, axis=-1)]

    h = rms_norm(x, norm1_g) * (1.0 + scale1) + shift1
    z = h @ w_in
    split_points = []
    acc = 0
    for sz in IN_SIZES[:-1]:
        acc += sz
        split_points.append(acc)
    a_u, a_v, q, k, v, qi, ki, wi, g_a, g_b = jnp.split(z, split_points, axis=-1)

    y_a = chunked_gmlp(jax.nn.gelu(a_u), jax.nn.gelu(a_v), gmlp_w_s, gmlp_b_s, gmlp_ln_g, gmlp_ln_b)

    q = partial_rope(q.reshape(bsz, s, N_HEADS, HEAD_DIM), positions, ROT_DIM)
    k = partial_rope(k.reshape(bsz, s, N_KV_HEADS, HEAD_DIM), positions, ROT_DIM)
    v = v.reshape(bsz, s, N_KV_HEADS, HEAD_DIM)
    qi = partial_rope(qi.reshape(bsz, s, IDX_HEADS, IDX_DIM), positions, IDX_ROT_DIM)
    ki = layer_norm(ki, idx_k_ln_g, idx_k_ln_b)
    ki = partial_rope(ki[:, :, None, :], positions, IDX_ROT_DIM)[:, :, 0, :]
    y_b = dsa_attention(q, k, v, qi, ki, wi)

    merged = jax.nn.sigmoid(g_a) * (y_a @ w_proj_a) + jax.nn.sigmoid(g_b) * (y_b @ w_proj_b)
    x = x + gate1 * (merged @ w_out)

    h2 = rms_norm(x, norm2_g) * (1.0 + scale2) + shift2
    f_g, f_u = jnp.split(h2 @ w_ffn_in, 2, axis=-1)
    x = x + gate2 * ((jax.nn.silu(f_g) * f_u) @ w_ffn_out)
    return x


def setup_inputs(seed: int = 0) -> dict:
    key = jax.random.key(seed)
    ks = jax.random.split(key, 24)
    f32 = jnp.float32
    nrm = lambda k_, shape, scale: jax.random.normal(k_, shape, f32) * scale
    d = D_MODEL
    x = jax.random.normal(ks[0], (BATCH, SEQ, d), f32)
    c = jax.random.normal(ks[1], (BATCH, d), f32)
    offset = jax.random.randint(ks[2], (BATCH, 1), 0, 1024, dtype=jnp.int32)
    positions = offset + jnp.arange(SEQ, dtype=jnp.int32)[None, :]
    return {
        "x": x,
        "c": c,
        "positions": positions,
        "w_ada": nrm(ks[3], (DEPTH, d, 6 * d), 0.5 * d ** -0.5),
        "b_ada": nrm(ks[4], (DEPTH, 6 * d), 0.02),
        "norm1_g": 1.0 + nrm(ks[5], (DEPTH, d), 0.02),
        "w_in": nrm(ks[6], (DEPTH, d, IN_COLS), d ** -0.5),
        "gmlp_ln_g": 1.0 + nrm(ks[7], (DEPTH, A_WIDTH), 0.02),
        "gmlp_ln_b": nrm(ks[8], (DEPTH, A_WIDTH), 0.02),
        "gmlp_w_s": nrm(ks[9], (DEPTH, A_GROUPS, CHUNK, CHUNK), 0.5 * CHUNK ** -0.5),
        "gmlp_b_s": 1.0 + nrm(ks[10], (DEPTH, A_GROUPS, CHUNK), 0.02),
        "idx_k_ln_g": 1.0 + nrm(ks[11], (DEPTH, IDX_DIM), 0.02),
        "idx_k_ln_b": nrm(ks[12], (DEPTH, IDX_DIM), 0.02),
        "w_proj_a": nrm(ks[13], (DEPTH, A_WIDTH, d), A_WIDTH ** -0.5),
        "w_proj_b": nrm(ks[14], (DEPTH, N_HEADS * HEAD_DIM, d), (N_HEADS * HEAD_DIM) ** -0.5),
        "w_out": nrm(ks[15], (DEPTH, d, d), d ** -0.5),
        "norm2_g": 1.0 + nrm(ks[16], (DEPTH, d), 0.02),
        "w_ffn_in": nrm(ks[17], (DEPTH, d, 2 * D_FF), d ** -0.5),
        "w_ffn_out": nrm(ks[18], (DEPTH, D_FF, d), D_FF ** -0.5),
        "final_norm_g": 1.0 + nrm(ks[19], (d,), 0.02),
    }


def reference(x, c, positions, w_ada, b_ada, norm1_g, w_in, gmlp_ln_g, gmlp_ln_b,
              gmlp_w_s, gmlp_b_s, idx_k_ln_g, idx_k_ln_b, w_proj_a, w_proj_b, w_out,
              norm2_g, w_ffn_in, w_ffn_out, final_norm_g):
    for l in range(DEPTH):
        x = hybrid_layer(x, c, positions, w_ada[l], b_ada[l], norm1_g[l], w_in[l],
                         gmlp_ln_g[l], gmlp_ln_b[l], gmlp_w_s[l], gmlp_b_s[l],
                         idx_k_ln_g[l], idx_k_ln_b[l], w_proj_a[l], w_proj_b[l], w_out[l],
                         norm2_g[l], w_ffn_in[l], w_ffn_out[l])
    return rms_norm(x, final_norm_g)
```

```cpp
#define MULTI_LAUNCH 1
#include <hip/hip_runtime.h>
#include <hip/hip_cooperative_groups.h>
#include <cstdio>
#include <cmath>
#include <cstring>
namespace cg = cooperative_groups;
namespace pg8 {
#define PG8_LAS __attribute__((address_space(3)))
typedef unsigned short bf16_t;
typedef short bf16x8 __attribute__((ext_vector_type(8)));
typedef float f32x4 __attribute__((ext_vector_type(4)));
typedef unsigned u32x4 __attribute__((ext_vector_type(4)));
constexpr int BM = 256, BK = 64, HALF = 128, HTB = HALF * BK * 2  , STAGE_BYTES = 8 * HTB, NXCD = 8, WGM = 8;

__host__ __device__ __forceinline__ int lds_byte(int r, int c) { const int st = (r >> 4) * 2 + (c >> 5), rr = r & 15, cc = c & 31, ob = rr * 64 + cc * 2; return st * 1024 + (ob ^ (((ob >> 9) & 1) << 5)); }
__host__ __device__ __forceinline__ void stage_rc(int b, int& R, int& C) { const int st = b / 1024, sb = b % 1024, swz = sb ^ (((sb >> 9) & 1) << 5); R = (st >> 1) * 16 + swz / 64; C = (st & 1) * 32 + (swz % 64) / 2; }
__host__ __device__ __forceinline__ int perm32(int rho) { const int n = rho >> 4, i = rho & 15; return 8 * (i >> 2) + 4 * n + (i & 3); }

struct Unit { int pm, pn; };
struct Gemm { const bf16_t* A; const bf16_t* Bt; int M, N, K; };
struct StaticOrder {
    int nM, nN, nwg, G, c;
    __host__ __device__ void init(int M, int N, int G_, int c_) { nM = M / BM; nN = N / BM; nwg = nM * nN; G = G_; c = c_; }
    __host__ __device__ bool next(int i, Unit& u) const {
        const long L = (long)i * G + c; if (L >= nwg) return false;
        int wgid = (int)L; { const int q = nwg / NXCD, r = nwg % NXCD, xcd = wgid % NXCD, off = wgid / NXCD; wgid = (xcd < r ? xcd * (q + 1) : r * (q + 1) + (xcd - r) * q) + off; }
        const int nig = WGM * nN, gid = wgid / nig, fm = gid * WGM, gsz = (nM - fm) < WGM ? (nM - fm) : WGM;
        u.pm = fm + ((wgid % nig) % gsz); u.pn = (wgid % nig) / gsz; return true;
    }
    __device__ __forceinline__ void a_ready(const Unit&) const {}
    __device__ __forceinline__ void done(const Unit&) const {}
};
__device__ __forceinline__ unsigned cvt_pk_bf16(float lo, float hi) { unsigned r; asm volatile("v_cvt_pk_bf16_f32 %0, %1, %2" : "=v"(r) : "v"(lo), "v"(hi)); return r; }
template <class Epi, class Sched, bool STAMP = false>
__device__ __forceinline__ void gemm_phase(PG8_LAS unsigned char* lds, const Gemm g, const Sched& S, const Epi& E, unsigned long long* stamps) {
    const int tid = threadIdx.x, wid = __builtin_amdgcn_readfirstlane(tid >> 6), lane = tid & 63, wr = wid >> 2, wc = wid & 3, fr = lane & 15, fq = lane >> 4;
    const int K = g.K, nt = K / BK;
    int ts_lo = 0, ts_hi = 0, nts = 0; const unsigned long long rt_entry = STAMP ? (unsigned long long)wall_clock64() : 0ull;
#define PG8_STAMP() do { if (STAMP && wid == 0 && nts < 64) { const unsigned long long _c = (unsigned long long)clock64(); \
        ts_lo = (lane == nts) ? (int)(unsigned)_c : ts_lo; ts_hi = (lane == nts) ? (int)(unsigned)(_c >> 32) : ts_hi; ++nts; } } while (0)
    PG8_STAMP();
    unsigned voffA[2], voffB[2];
#pragma unroll
    for (int i = 0; i < 2; ++i) { int R, C; stage_rc(tid * 16 + i * 8192, R, C); const int Rb = Epi::PERM ? ((R & ~31) + perm32(R & 31)) : R;
        voffA[i] = (unsigned)(R * K + C) * 2u; voffB[i] = (unsigned)(Rb * K + C) * 2u; }
    const size_t kstep = (size_t)(BK * 2);
    const size_t hstep = (size_t)HALF * K * 2;
    const size_t tstep = 2 * hstep;
    const unsigned ldsw = (unsigned)wid * 1024u;
    const int aoff = lds_byte(wr * 64 + fr, fq * 8), boff = lds_byte(wc * 32 + fr, fq * 8);
#define PG8_SA(b, h) (((b) * 2 + (h)) * HTB)
#define PG8_SB(b, h) ((4 + (b) * 2 + (h)) * HTB)
#define PG8_STAGE(bufoff, gbase, voff) do { _Pragma("unroll") for (int _i = 0; _i < 2; ++_i) \
        __builtin_amdgcn_global_load_lds((const unsigned*)((const char*)(gbase) + (voff)[_i]), (PG8_LAS unsigned*)(lds + (bufoff) + ldsw + _i * 8192), 16, 0, 0); } while (0)
#define PG8_LDA(dst, b, h) do { _Pragma("unroll") for (int m = 0; m < 4; ++m) _Pragma("unroll") for (int k = 0; k < 2; ++k) dst[m][k] = *(const PG8_LAS bf16x8*)(lds + PG8_SA(b, h) + aoff + m * 2048 + k * 1024); } while (0)
#define PG8_LDB(dst, b, h) do { _Pragma("unroll") for (int n = 0; n < 2; ++n) _Pragma("unroll") for (int k = 0; k < 2; ++k) dst[n][k] = *(const PG8_LAS bf16x8*)(lds + PG8_SB(b, h) + boff + n * 2048 + k * 1024); } while (0)
#define PG8_MMA(ai, bj, At, Bt) do { __builtin_amdgcn_s_setprio(1); _Pragma("unroll") for (int m = 0; m < 4; ++m) _Pragma("unroll") for (int n = 0; n < 2; ++n) _Pragma("unroll") for (int k = 0; k < 2; ++k) \
        acc[ai][bj][m][n] = __builtin_amdgcn_mfma_f32_16x16x32_bf16(Bt[n][k], At[m][k], acc[ai][bj][m][n], 0, 0, 0); __builtin_amdgcn_s_setprio(0); } while (0)
#define PG8_WAIT_V(n) asm volatile("s_waitcnt vmcnt(" #n ")" ::: "memory")
#define PG8_WAIT_L(n) asm volatile("s_waitcnt lgkmcnt(" #n ")" ::: "memory")
#define PG8_BAR __builtin_amdgcn_s_barrier()
#define PG8_SCHED __builtin_amdgcn_sched_barrier(0)
    Unit cur, nxt; int ui = 0;
    if (!S.next(0, cur)) return;
    f32x4 acc[2][2][4][2];
#pragma unroll
    for (int a = 0; a < 2; ++a)
#pragma unroll
        for (int b = 0; b < 2; ++b)
#pragma unroll
            for (int m = 0; m < 4; ++m)
#pragma unroll
                for (int n = 0; n < 2; ++n) acc[a][b][m][n] = (f32x4){0.f, 0.f, 0.f, 0.f};
    bf16x8 At[4][2], B0[2][2], B1[2][2];
    const char* cA = (const char*)g.A + (size_t)cur.pm * tstep; const char* cB = (const char*)g.Bt + (size_t)cur.pn * tstep;
    S.a_ready(cur);
    PG8_STAGE(PG8_SB(0, 0), cB, voffB); PG8_STAGE(PG8_SA(0, 0), cA, voffA); PG8_STAGE(PG8_SB(0, 1), cB + hstep, voffB); PG8_STAGE(PG8_SA(0, 1), cA + hstep, voffA);
    if (wr == 1) PG8_BAR;
    PG8_WAIT_V(4); PG8_BAR;
    PG8_STAGE(PG8_SB(1, 0), cB + kstep, voffB); PG8_STAGE(PG8_SA(1, 0), cA + kstep, voffA); PG8_STAGE(PG8_SB(1, 1), cB + hstep + kstep, voffB);
    PG8_WAIT_V(6); PG8_BAR;
    PG8_STAMP();
    for (;;) {
        const bool has_next = S.next(ui + 1, nxt);
        const char* nA = has_next ? (const char*)g.A + (size_t)nxt.pm * tstep : cA; const char* nB = has_next ? (const char*)g.Bt + (size_t)nxt.pn * tstep : cB;
        for (int t = 0; t < nt; t += 2) {
            const bool last = (t == nt - 2);
            const char* a1 = cA + (size_t)(t + 1) * kstep;
            const char* a2 = last ? nA : cA + (size_t)(t + 2) * kstep; const char* b2 = last ? nB : cB + (size_t)(t + 2) * kstep;
            const char* a3 = a2 + kstep; const char* b3 = b2 + kstep;
            if (last && has_next) S.a_ready(nxt);
            PG8_LDB(B0, 0, 0); PG8_SCHED; PG8_LDA(At, 0, 0); PG8_STAGE(PG8_SA(1, 1), a1 + hstep, voffA);
            PG8_WAIT_L(8); PG8_BAR; PG8_WAIT_L(0); PG8_MMA(0, 0, At, B0); PG8_BAR; PG8_SCHED;
            PG8_LDB(B1, 0, 1); PG8_STAGE(PG8_SB(0, 0), b2, voffB);
            PG8_BAR; PG8_WAIT_L(0); PG8_MMA(0, 1, At, B1); PG8_BAR;
            PG8_LDA(At, 0, 1); PG8_STAGE(PG8_SA(0, 0), a2, voffA);
            PG8_BAR; PG8_WAIT_L(0); PG8_MMA(1, 0, At, B0); PG8_BAR; PG8_SCHED;
            PG8_STAGE(PG8_SB(0, 1), b2 + hstep, voffB);
            PG8_WAIT_V(6); PG8_BAR; PG8_MMA(1, 1, At, B1); PG8_BAR;
            PG8_LDB(B0, 1, 0); PG8_SCHED; PG8_LDA(At, 1, 0); PG8_STAGE(PG8_SA(0, 1), a2 + hstep, voffA);
            PG8_WAIT_L(8); PG8_BAR; PG8_WAIT_L(0); PG8_MMA(0, 0, At, B0); PG8_BAR; PG8_SCHED;
            PG8_LDB(B1, 1, 1); PG8_STAGE(PG8_SB(1, 0), b3, voffB);
            PG8_BAR; PG8_WAIT_L(0); PG8_MMA(0, 1, At, B1); PG8_BAR;
            PG8_LDA(At, 1, 1); PG8_STAGE(PG8_SA(1, 0), a3, voffA);
            PG8_BAR; PG8_WAIT_L(0); PG8_MMA(1, 0, At, B0); PG8_BAR; PG8_SCHED;
            PG8_STAGE(PG8_SB(1, 1), b3 + hstep, voffB);
            PG8_WAIT_V(6); PG8_BAR; PG8_MMA(1, 1, At, B1); PG8_BAR;
        }
        PG8_STAMP();
        if constexpr (!Epi::AFTER_DRAIN) { E(acc, cur, wr, wc, fr, fq); S.done(cur); }
        PG8_STAMP();
        if (!has_next) break;
#pragma unroll
        for (int a = 0; a < 2; ++a)
#pragma unroll
            for (int b = 0; b < 2; ++b)
#pragma unroll
                for (int m = 0; m < 4; ++m)
#pragma unroll
                    for (int n = 0; n < 2; ++n) acc[a][b][m][n] = (f32x4){0.f, 0.f, 0.f, 0.f};
        cur = nxt; cA = nA; cB = nB; ++ui;
    }
    PG8_WAIT_V(0);
    if (wr == 0) PG8_BAR;
    PG8_BAR;
    if constexpr (Epi::AFTER_DRAIN) { E.fused(acc, cur, wr, wc, fr, fq, lds, wid, lane); S.done(cur); }
    PG8_STAMP();
    if (STAMP && wid == 0) { stamps[lane] = lane < nts ? (((unsigned long long)(unsigned)ts_hi << 32) | (unsigned)ts_lo) : 0ull;
        if (lane == 62) stamps[62] = rt_entry; if (lane == 63) stamps[63] = (unsigned long long)wall_clock64(); }
#undef PG8_STAMP
#undef PG8_SA
#undef PG8_SB
#undef PG8_STAGE
#undef PG8_LDA
#undef PG8_LDB
#undef PG8_MMA
#undef PG8_WAIT_V
#undef PG8_WAIT_L
#undef PG8_BAR
#undef PG8_SCHED
}
}

using pg8::bf16_t; using pg8::bf16x8; using pg8::f32x4; using pg8::u32x4; using pg8::Unit;
typedef float f32x16 __attribute__((ext_vector_type(16)));
typedef float f32x2 __attribute__((ext_vector_type(2)));
typedef unsigned u32x2 __attribute__((ext_vector_type(2)));
typedef __bf16 bf16v2 __attribute__((ext_vector_type(2)));
#define DI __device__ __forceinline__

constexpr int T_ = 16384, S_ = 4096, DFF_ = 2816;
constexpr float QSCALE = 0.08838834764831845f * 1.4426950408889634f;

__constant__ float INVF[24] = {
    1.000000000e+00f, 4.403665960e-01f, 1.939227432e-01f, 8.539710194e-02f, 3.760603070e-02f, 1.656043902e-02f, 7.292664610e-03f, 3.211445874e-03f,
    1.414213562e-03f, 6.227723788e-04f, 2.742481884e-04f, 1.207697351e-04f, 5.318296098e-05f, 2.341999971e-05f, 1.031338616e-05f, 4.541670478e-06f,
    1.000000000e+00f, 1.939227432e-01f, 3.760603070e-02f, 7.292664610e-03f, 1.414213562e-03f, 2.742481884e-04f, 5.318296098e-05f, 1.031338616e-05f};

struct Params {
    const float *x, *c; const int* pos;
    const float *w_ada, *b_ada, *norm1_g, *w_in, *ln_g, *ln_b, *w_s, *b_s, *kln_g, *kln_b, *w_pa, *w_pb, *w_out, *norm2_g, *w_f1, *w_f2, *fin_g;
    float* out;
    bf16_t *WtIn, *WtPa, *WtPb, *WtOut, *WtF1, *WtF2;
    float *mod, *rope;
    bf16_t *H, *U, *Vg, *Q, *Kk, *VT, *QI, *KIn;
    float *WI, *stats; unsigned* mask;
    bf16_t *GA, *GB, *Mg, *Hff;
};

DI unsigned pk2(float lo, float hi) { f32x2 v = {lo, hi}; bf16v2 b = __builtin_convertvector(v, bf16v2); return __builtin_bit_cast(unsigned, b); }
DI float bf_lo(unsigned u) { return __uint_as_float(u << 16); }
DI float bf_hi(unsigned u) { return __uint_as_float(u & 0xffff0000u); }
DI float gelu_tanh(float x) { const float y = x + 0.044715f * x * x * x; return x * __builtin_amdgcn_rcpf(1.0f + __builtin_amdgcn_exp2f(-2.3022082f * y)); }
DI float sigmoidf_(float x) { return __builtin_amdgcn_rcpf(1.0f + __builtin_amdgcn_exp2f(-1.4426950409f * x)); }
DI u32x4 pack8(const f32x4& a, const f32x4& b) { u32x4 w; w.x = pk2(a[0], a[1]); w.y = pk2(a[2], a[3]); w.z = pk2(b[0], b[1]); w.w = pk2(b[2], b[3]); return w; }

DI int srccol_in(int n) {
    if (n < 4096) return n;
    if (n < 6144) return n + 72;
    const int l = n - 6144;
    if (l < 32) return 4096 + l;
    if (l < 40) return 4160 + (l - 32);
    if (l >= 128 && l < 160) return 4128 + (l - 128);
    return -1;
}
DI int srccol_f1(int n) { const int t = n >> 8, r = n & 255; return (r >> 7) * DFF_ + t * 128 + (r & 127); }

template <int MAP> DI void tr_tile(const float* __restrict__ src, int ldsrc, bf16_t* __restrict__ dst, int K, int k0, int n0, float* tile) {
    const int tid = threadIdx.x, nn = tid & 63, kk0 = tid >> 6;
    const int n = n0 + nn; const int sc = MAP == 0 ? n : (MAP == 1 ? srccol_in(n) : srccol_f1(n));
#pragma unroll
    for (int i = 0; i < 8; ++i) { const int kk = kk0 + 8 * i; tile[kk * 65 + nn] = sc >= 0 ? src[(size_t)(k0 + kk) * ldsrc + sc] : 0.f; }
    __syncthreads();
    const int rn = tid >> 3, kq = (tid & 7) * 8;
    f32x4 a, b;
#pragma unroll
    for (int e = 0; e < 4; ++e) { a[e] = tile[(kq + e) * 65 + rn]; b[e] = tile[(kq + 4 + e) * 65 + rn]; }
    *(u32x4*)(dst + (size_t)(n0 + rn) * K + k0 + kq) = pack8(a, b);
    __syncthreads();
}

DI void mod_item(const Params& p, int cg_, float* lds) {
    float* sc = lds; float* red = lds + 4096;
    const int tid = threadIdx.x;
    for (int i = tid; i < 4096; i += 512) { const float v = p.c[i]; sc[i] = v / (1.0f + expf(-v)); }
    __syncthreads();
    const int j = tid & 31, ks = tid >> 5;
    float a0 = 0.f, a1 = 0.f, a2 = 0.f, a3 = 0.f;
    const float* w = p.w_ada + (size_t)(ks * 64) * 6144 + cg_ * 32 + j;
#pragma unroll 16
    for (int kk = 0; kk < 64; ++kk) { const float wv = w[(size_t)kk * 6144]; const int k = ks * 64 + kk; a0 += sc[k] * wv; a1 += sc[1024 + k] * wv; a2 += sc[2048 + k] * wv; a3 += sc[3072 + k] * wv; }
    red[(ks * 32 + j) * 4 + 0] = a0; red[(ks * 32 + j) * 4 + 1] = a1; red[(ks * 32 + j) * 4 + 2] = a2; red[(ks * 32 + j) * 4 + 3] = a3;
    __syncthreads();
    if (tid < 128) { const int jj = tid >> 2, b = tid & 3; float s = 0.f;
#pragma unroll
        for (int k2 = 0; k2 < 16; ++k2) s += red[(k2 * 32 + jj) * 4 + b];
        const int col = cg_ * 32 + jj; p.mod[b * 6144 + col] = s + p.b_ada[col]; }
    __syncthreads();
}

DI void phase0(const Params& p, unsigned char* smem) {
    float* lds = (float*)smem;
    constexpr int N0 = 1600, N1 = 256, N4 = 1408, N5 = 704, NMOD = 192;
    constexpr int TOT = N0 + 3 * N1 + N4 + N5 + NMOD;
    for (int it = blockIdx.x; it < TOT; it += gridDim.x) {
        int i = it;
        if (i < NMOD) { mod_item(p, i, lds); continue; }
        i -= NMOD;
        if (i < N0) { tr_tile<1>(p.w_in, 6216, p.WtIn, 1024, (i / 100) * 64, (i % 100) * 64, lds); continue; }
        i -= N0;
        if (i < 3 * N1) { const int m = i / N1, j = i % N1; const float* s = m == 0 ? p.w_pa : (m == 1 ? p.w_pb : p.w_out); bf16_t* d = m == 0 ? p.WtPa : (m == 1 ? p.WtPb : p.WtOut);
            tr_tile<0>(s, 1024, d, 1024, (j / 16) * 64, (j % 16) * 64, lds); continue; }
        i -= 3 * N1;
        if (i < N4) { tr_tile<2>(p.w_f1, 2 * DFF_, p.WtF1, 1024, (i / 88) * 64, (i % 88) * 64, lds); continue; }
        i -= N4;
        tr_tile<0>(p.w_f2, 1024, p.WtF2, DFF_, (i / 16) * 64, (i % 16) * 64, lds);
    }
}

template <int MODE> DI void rownorm_phase(const Params& p) {
    const int tid = threadIdx.x, lane = tid & 63;
    const int wave = blockIdx.x * 8 + (tid >> 6), nw = gridDim.x * 8;
    for (int row = wave; row < T_; row += nw) {
        const float* src = (MODE == 0 ? p.x : p.out) + (size_t)row * 1024;
        f32x4 v[4]; float ss = 0.f;
#pragma unroll
        for (int r = 0; r < 4; ++r) { v[r] = *(const f32x4*)(src + r * 256 + lane * 4); ss += v[r][0] * v[r][0] + v[r][1] * v[r][1] + v[r][2] * v[r][2] + v[r][3] * v[r][3]; }
#pragma unroll
        for (int o = 32; o >= 1; o >>= 1) ss += __shfl_xor(ss, o);
        const float rstd = 1.0f / sqrtf(ss * (1.0f / 1024.0f) + 1e-6f);
        const int b = row >> 12;
        const float* gp = MODE == 0 ? p.norm1_g : (MODE == 1 ? p.norm2_g : p.fin_g);
#pragma unroll
        for (int r = 0; r < 4; ++r) {
            const int idx = r * 256 + lane * 4;
            const f32x4 g = *(const f32x4*)(gp + idx);
            f32x4 y = v[r] * rstd * g;
            if (MODE < 2) {
                const f32x4 sc = *(const f32x4*)(p.mod + b * 6144 + (MODE == 0 ? 1024 : 4096) + idx);
                const f32x4 sh = *(const f32x4*)(p.mod + b * 6144 + (MODE == 0 ? 0 : 3072) + idx);
                y = y * (1.0f + sc) + sh;
                u32x2 w; w.x = pk2(y[0], y[1]); w.y = pk2(y[2], y[3]);
                *(u32x2*)(p.H + (size_t)row * 1024 + idx) = w;
            } else {
                *(f32x4*)(p.out + (size_t)row * 1024 + idx) = y;
            }
        }
        if (MODE == 0 && lane < 24) {
            const float ang = (float)p.pos[row] * INVF[lane];
            float sn, cs; sincosf(ang, &sn, &cs);
            float* rp = p.rope + (size_t)row * 48;
            if (lane < 16) { rp[lane] = cs; rp[16 + lane] = sn; } else { rp[32 + lane - 16] = cs; rp[40 + lane - 16] = sn; }
        }
    }
}

struct EpiIn {
    static constexpr bool PERM = true, AFTER_DRAIN = false;
    Params p;
    __device__ __forceinline__ void operator()(const f32x4 (&acc)[2][2][4][2], const Unit& u, int wr, int wc, int fr, int fq) const {
        const int pn = u.pn;
        const int row0 = u.pm * 256 + wr * 64 + fr;
        const int cw = wc * 32 + 8 * fq;
        if (pn < 8) {
            bf16_t* O = pn < 4 ? p.U : p.Vg; const int pl = pn & 3;
#pragma unroll
            for (int ai = 0; ai < 2; ++ai)
#pragma unroll
                for (int m = 0; m < 4; ++m) {
                    const int row = row0 + ai * 128 + m * 16; float s1 = 0.f, s2 = 0.f;
#pragma unroll
                    for (int bj = 0; bj < 2; ++bj) {
                        f32x4 a, b;
#pragma unroll
                        for (int j = 0; j < 4; ++j) { a[j] = gelu_tanh(acc[ai][bj][m][0][j]); b[j] = gelu_tanh(acc[ai][bj][m][1][j]); s1 += a[j] + b[j]; s2 += a[j] * a[j] + b[j] * b[j]; }
                        *(u32x4*)(O + (size_t)row * 1024 + pl * 256 + bj * 128 + cw) = pack8(a, b);
                    }
                    if (pn >= 4) {
                        s1 += __shfl_xor(s1, 16); s2 += __shfl_xor(s2, 16); s1 += __shfl_xor(s1, 32); s2 += __shfl_xor(s2, 32);
                        if (fq == 0) { f32x2 st = {s1, s2}; *(f32x2*)(p.stats + ((size_t)row * 16 + pl * 4 + wc) * 2) = st; }
                    }
                }
        } else if (pn < 13) {
            const bool isq = pn < 12; const int pl = isq ? pn - 8 : 0; const int ld = isq ? 1024 : 256; bf16_t* O = isq ? p.Q : p.Kk; const float scl = isq ? QSCALE : 1.0f;
#pragma unroll
            for (int ai = 0; ai < 2; ++ai)
#pragma unroll
                for (int m = 0; m < 4; ++m) {
                    const int row = row0 + ai * 128 + m * 16;
                    f32x4 cs[2], sn[2];
                    if (wc == 0) { const float* rp = p.rope + (size_t)row * 48 + 8 * (fq & 1); cs[0] = *(const f32x4*)rp; cs[1] = *(const f32x4*)(rp + 4); sn[0] = *(const f32x4*)(rp + 16); sn[1] = *(const f32x4*)(rp + 20); }
#pragma unroll
                    for (int bj = 0; bj < 2; ++bj) {
                        f32x4 v[2] = {acc[ai][bj][m][0], acc[ai][bj][m][1]};
                        if (wc == 0) {
#pragma unroll
                            for (int n = 0; n < 2; ++n)
#pragma unroll
                                for (int j = 0; j < 4; ++j) { const float x = v[n][j]; const float pr = __shfl_xor(x, 32); v[n][j] = fq < 2 ? x * cs[n][j] - pr * sn[n][j] : x * cs[n][j] + pr * sn[n][j]; }
                        }
                        v[0] *= scl; v[1] *= scl;
                        *(u32x4*)(O + (size_t)row * ld + pl * 256 + bj * 128 + cw) = pack8(v[0], v[1]);
                    }
                }
        } else if (pn == 13) {
#pragma unroll
            for (int ai = 0; ai < 2; ++ai)
#pragma unroll
                for (int m = 0; m < 4; ++m) {
                    const int row = row0 + ai * 128 + m * 16; const int b = row >> 12, s = row & 4095;
#pragma unroll
                    for (int bj = 0; bj < 2; ++bj)
#pragma unroll
                        for (int n = 0; n < 2; ++n)
#pragma unroll
                            for (int j = 0; j < 4; ++j) { const int col = bj * 128 + cw + 4 * n + j; const unsigned w = pk2(acc[ai][bj][m][n][j], 0.f); p.VT[((size_t)(b * 256 + col)) * 4096 + s] = (bf16_t)(w & 0xffffu); }
                }
        } else if (pn < 16) {
            const int pl = pn - 14; const bool rot = (wc & 1) == 0;
#pragma unroll
            for (int ai = 0; ai < 2; ++ai)
#pragma unroll
                for (int m = 0; m < 4; ++m) {
                    const int row = row0 + ai * 128 + m * 16;
                    f32x4 cs[2], sn[2];
                    if (rot) { const float* rp = p.rope + (size_t)row * 48 + 32; cs[0] = *(const f32x4*)rp; cs[1] = *(const f32x4*)(rp + 4); sn[0] = *(const f32x4*)(rp + 8); sn[1] = *(const f32x4*)(rp + 12); }
#pragma unroll
                    for (int bj = 0; bj < 2; ++bj) {
                        f32x4 v[2] = {acc[ai][bj][m][0], acc[ai][bj][m][1]};
                        if (rot) {
#pragma unroll
                            for (int n = 0; n < 2; ++n)
#pragma unroll
                                for (int j = 0; j < 4; ++j) { const float x = v[n][j]; const float pr = __shfl_xor(x, 16); const float r1 = x * cs[n][j] - pr * sn[n][j], r2 = x * cs[n][j] + pr * sn[n][j]; v[n][j] = fq == 0 ? r1 : (fq == 1 ? r2 : x); }
                        }
                        *(u32x4*)(p.QI + (size_t)row * 512 + pl * 256 + bj * 128 + cw) = pack8(v[0], v[1]);
                    }
                }
        } else if (pn < 24) {
            bf16_t* O = pn < 20 ? p.GA : p.GB; const int pl = (pn - 16) & 3;
#pragma unroll
            for (int ai = 0; ai < 2; ++ai)
#pragma unroll
                for (int m = 0; m < 4; ++m) {
                    const int row = row0 + ai * 128 + m * 16;
#pragma unroll
                    for (int bj = 0; bj < 2; ++bj) {
                        f32x4 a, b;
#pragma unroll
                        for (int j = 0; j < 4; ++j) { a[j] = sigmoidf_(acc[ai][bj][m][0][j]); b[j] = sigmoidf_(acc[ai][bj][m][1][j]); }
                        *(u32x4*)(O + (size_t)row * 1024 + pl * 256 + bj * 128 + cw) = pack8(a, b);
                    }
                }
        } else {
            if (wc == 0) {
                f32x4 lg[2][2], lb[2][2];
#pragma unroll
                for (int bj = 0; bj < 2; ++bj)
#pragma unroll
                    for (int n = 0; n < 2; ++n) { lg[bj][n] = *(const f32x4*)(p.kln_g + bj * 32 + 8 * fq + 4 * n); lb[bj][n] = *(const f32x4*)(p.kln_b + bj * 32 + 8 * fq + 4 * n); }
#pragma unroll
                for (int ai = 0; ai < 2; ++ai)
#pragma unroll
                    for (int m = 0; m < 4; ++m) {
                        const int row = row0 + ai * 128 + m * 16;
                        float s1 = 0.f;
#pragma unroll
                        for (int bj = 0; bj < 2; ++bj)
#pragma unroll
                            for (int n = 0; n < 2; ++n)
#pragma unroll
                                for (int j = 0; j < 4; ++j) s1 += acc[ai][bj][m][n][j];
                        s1 += __shfl_xor(s1, 16); s1 += __shfl_xor(s1, 32);
                        const float mean = s1 * (1.0f / 64.0f);
                        float s2 = 0.f;
#pragma unroll
                        for (int bj = 0; bj < 2; ++bj)
#pragma unroll
                            for (int n = 0; n < 2; ++n)
#pragma unroll
                                for (int j = 0; j < 4; ++j) { const float d = acc[ai][bj][m][n][j] - mean; s2 += d * d; }
                        s2 += __shfl_xor(s2, 16); s2 += __shfl_xor(s2, 32);
                        const float rstd = 1.0f / sqrtf(s2 * (1.0f / 64.0f) + 1e-6f);
                        const float* rp = p.rope + (size_t)row * 48 + 32;
                        const f32x4 cs[2] = {*(const f32x4*)rp, *(const f32x4*)(rp + 4)}, sn[2] = {*(const f32x4*)(rp + 8), *(const f32x4*)(rp + 12)};
#pragma unroll
                        for (int bj = 0; bj < 2; ++bj) {
                            f32x4 v[2];
#pragma unroll
                            for (int n = 0; n < 2; ++n) v[n] = (acc[ai][bj][m][n] - mean) * rstd * lg[bj][n] + lb[bj][n];
                            if (bj == 0) {
#pragma unroll
                                for (int n = 0; n < 2; ++n)
#pragma unroll
                                    for (int j = 0; j < 4; ++j) { const float x = v[n][j]; const float pr = __shfl_xor(x, 16); const float r1 = x * cs[n][j] - pr * sn[n][j], r2 = x * cs[n][j] + pr * sn[n][j]; v[n][j] = fq == 0 ? r1 : (fq == 1 ? r2 : x); }
                            }
                            *(u32x4*)(p.KIn + (size_t)row * 64 + bj * 32 + 8 * fq) = pack8(v[0], v[1]);
                        }
                    }
            } else if (wc == 1 && fq == 0) {
#pragma unroll
                for (int ai = 0; ai < 2; ++ai)
#pragma unroll
                    for (int m = 0; m < 4; ++m) {
                        const int row = row0 + ai * 128 + m * 16;
                        *(f32x4*)(p.WI + (size_t)row * 8) = acc[ai][0][m][0]; *(f32x4*)(p.WI + (size_t)row * 8 + 4) = acc[ai][0][m][1];
                    }
            }
        }
    }
};

struct EpiMergeA {
    static constexpr bool PERM = true, AFTER_DRAIN = false;
    bf16_t* GA;
    __device__ __forceinline__ void operator()(const f32x4 (&acc)[2][2][4][2], const Unit& u, int wr, int wc, int fr, int fq) const {
        const int row0 = u.pm * 256 + wr * 64 + fr, col0 = u.pn * 256 + wc * 32 + 8 * fq;
#pragma unroll
        for (int ai = 0; ai < 2; ++ai)
#pragma unroll
            for (int m = 0; m < 4; ++m)
#pragma unroll
                for (int bj = 0; bj < 2; ++bj) {
                    bf16_t* ptr = GA + (size_t)(row0 + ai * 128 + m * 16) * 1024 + col0 + bj * 128;
                    const u32x4 g = *(const u32x4*)ptr;
                    const f32x4 a0 = acc[ai][bj][m][0], a1 = acc[ai][bj][m][1];
                    f32x4 o0 = {bf_lo(g.x) * a0[0], bf_hi(g.x) * a0[1], bf_lo(g.y) * a0[2], bf_hi(g.y) * a0[3]};
                    f32x4 o1 = {bf_lo(g.z) * a1[0], bf_hi(g.z) * a1[1], bf_lo(g.w) * a1[2], bf_hi(g.w) * a1[3]};
                    *(u32x4*)ptr = pack8(o0, o1);
                }
    }
};
struct EpiMergeB {
    static constexpr bool PERM = true, AFTER_DRAIN = false;
    const bf16_t *M1, *GB; bf16_t* Mg;
    __device__ __forceinline__ void operator()(const f32x4 (&acc)[2][2][4][2], const Unit& u, int wr, int wc, int fr, int fq) const {
        const int row0 = u.pm * 256 + wr * 64 + fr, col0 = u.pn * 256 + wc * 32 + 8 * fq;
#pragma unroll
        for (int ai = 0; ai < 2; ++ai)
#pragma unroll
            for (int m = 0; m < 4; ++m)
#pragma unroll
                for (int bj = 0; bj < 2; ++bj) {
                    const size_t off = (size_t)(row0 + ai * 128 + m * 16) * 1024 + col0 + bj * 128;
                    const u32x4 g = *(const u32x4*)(GB + off), q = *(const u32x4*)(M1 + off);
                    const f32x4 a0 = acc[ai][bj][m][0], a1 = acc[ai][bj][m][1];
                    f32x4 o0 = {bf_lo(q.x) + bf_lo(g.x) * a0[0], bf_hi(q.x) + bf_hi(g.x) * a0[1], bf_lo(q.y) + bf_lo(g.y) * a0[2], bf_hi(q.y) + bf_hi(g.y) * a0[3]};
                    f32x4 o1 = {bf_lo(q.z) + bf_lo(g.z) * a1[0], bf_hi(q.z) + bf_hi(g.z) * a1[1], bf_lo(q.w) + bf_lo(g.w) * a1[2], bf_hi(q.w) + bf_hi(g.w) * a1[3]};
                    *(u32x4*)(Mg + off) = pack8(o0, o1);
                }
    }
};
struct EpiRes {
    static constexpr bool PERM = false, AFTER_DRAIN = false;
    const float* base; const float* gate  ; float* out;
    __device__ __forceinline__ void operator()(const f32x4 (&acc)[2][2][4][2], const Unit& u, int wr, int wc, int fr, int fq) const {
        const int row0 = u.pm * 256 + wr * 64 + fr, col0 = u.pn * 256 + wc * 32 + 4 * fq;
        const int b = (u.pm * 256) >> 12;
        f32x4 gv[2][2];
#pragma unroll
        for (int bj = 0; bj < 2; ++bj)
#pragma unroll
            for (int n = 0; n < 2; ++n) gv[bj][n] = *(const f32x4*)(gate + b * 6144 + col0 + bj * 128 + n * 16);
#pragma unroll
        for (int ai = 0; ai < 2; ++ai)
#pragma unroll
            for (int m = 0; m < 4; ++m) {
                const size_t ro = (size_t)(row0 + ai * 128 + m * 16) * 1024 + col0;
#pragma unroll
                for (int bj = 0; bj < 2; ++bj)
#pragma unroll
                    for (int n = 0; n < 2; ++n) { const f32x4 bv = *(const f32x4*)(base + ro + bj * 128 + n * 16); *(f32x4*)(out + ro + bj * 128 + n * 16) = bv + gv[bj][n] * acc[ai][bj][m][n]; }
            }
    }
};
struct EpiF1 {
    static constexpr bool PERM = true, AFTER_DRAIN = false;
    bf16_t* Hff;
    __device__ __forceinline__ void operator()(const f32x4 (&acc)[2][2][4][2], const Unit& u, int wr, int wc, int fr, int fq) const {
        const int row0 = u.pm * 256 + wr * 64 + fr, col0 = u.pn * 128 + wc * 32 + 8 * fq;
#pragma unroll
        for (int ai = 0; ai < 2; ++ai)
#pragma unroll
            for (int m = 0; m < 4; ++m) {
                f32x4 o[2];
#pragma unroll
                for (int n = 0; n < 2; ++n)
#pragma unroll
                    for (int j = 0; j < 4; ++j) { const float g = acc[ai][0][m][n][j]; o[n][j] = g * sigmoidf_(g) * acc[ai][1][m][n][j]; }
                *(u32x4*)(Hff + (size_t)(row0 + ai * 128 + m * 16) * DFF_ + col0) = pack8(o[0], o[1]);
            }
    }
};

template <class Epi> DI void run_gemm(unsigned char* smem, const bf16_t* A, const bf16_t* Bt, int M, int N, int K, const Epi& E) {
    pg8::StaticOrder So; So.init(M, N, (int)gridDim.x, (int)blockIdx.x);
    pg8::Gemm g{A, Bt, M, N, K};
    pg8::gemm_phase<Epi, pg8::StaticOrder, false>((PG8_LAS unsigned char*)smem, g, So, E, nullptr);
    __syncthreads();
}

DI void gmlp_item(const Params& p, int it, unsigned char* smem) {
    const int tid = threadIdx.x, w = tid >> 6, lane = tid & 63, fr = lane & 15, fq = lane >> 4;
    const int g = it & 7, bn = it >> 3, row0 = bn * 128, c0 = g * 128;
    bf16_t* WsL = (bf16_t*)smem; bf16_t* VnT = (bf16_t*)(smem + 128 * 272);
    float* mu = (float*)(smem + 2 * 128 * 272); float* rs = mu + 128;
    if (tid < 128) {
        const f32x2* sp = (const f32x2*)p.stats + (size_t)(row0 + tid) * 16; float s1 = 0.f, s2 = 0.f;
#pragma unroll
        for (int i = 0; i < 16; ++i) { const f32x2 v = sp[i]; s1 += v.x; s2 += v.y; }
        const float mean = s1 * (1.0f / 1024.0f); const float var = fmaxf(s2 * (1.0f / 1024.0f) - mean * mean, 0.f);
        mu[tid] = mean; rs[tid] = 1.0f / sqrtf(var + 1e-6f);
    }
#pragma unroll
    for (int i = 0; i < 8; ++i) {
        const int idx = (tid + 512 * i) * 4, t = idx >> 7, s = idx & 127;
        f32x4 wv = *(const f32x4*)(p.w_s + g * 16384 + idx);
#pragma unroll
        for (int e = 0; e < 4; ++e) if (s + e > t) wv[e] = 0.f;
        u32x2 o; o.x = pk2(wv[0], wv[1]); o.y = pk2(wv[2], wv[3]);
        *(u32x2*)(WsL + t * 136 + s) = o;
    }
    __syncthreads();
    {
        const int s = tid & 127, cq = tid >> 7; const float m_ = mu[s], r_ = rs[s];
#pragma unroll
        for (int i = 0; i < 4; ++i) {
            const int c = (cq + 4 * i) * 8;
            const u32x4 raw = *(const u32x4*)(p.Vg + (size_t)(row0 + s) * 1024 + c0 + c);
            const f32x4 g0 = *(const f32x4*)(p.ln_g + c0 + c), g1 = *(const f32x4*)(p.ln_g + c0 + c + 4), b0 = *(const f32x4*)(p.ln_b + c0 + c), b1 = *(const f32x4*)(p.ln_b + c0 + c + 4);
            float v[8] = {bf_lo(raw.x), bf_hi(raw.x), bf_lo(raw.y), bf_hi(raw.y), bf_lo(raw.z), bf_hi(raw.z), bf_lo(raw.w), bf_hi(raw.w)};
#pragma unroll
            for (int e = 0; e < 8; ++e) { const float gg = e < 4 ? g0[e & 3] : g1[e & 3], bb = e < 4 ? b0[e & 3] : b1[e & 3]; const float y = (v[e] - m_) * r_ * gg + bb; VnT[(c + e) * 136 + s] = (bf16_t)(pk2(y, 0.f) & 0xffffu); }
        }
    }
    __syncthreads();
    const int wr = w >> 2, wc = w & 3;
    f32x4 acc[4][2];
#pragma unroll
    for (int m = 0; m < 4; ++m)
#pragma unroll
        for (int n = 0; n < 2; ++n) acc[m][n] = (f32x4){0.f, 0.f, 0.f, 0.f};
#pragma unroll
    for (int ks = 0; ks < 4; ++ks) {
        bf16x8 tf[4], cf[2];
#pragma unroll
        for (int m = 0; m < 4; ++m) tf[m] = *(const bf16x8*)(WsL + (wr * 64 + m * 16 + fr) * 136 + ks * 32 + fq * 8);
#pragma unroll
        for (int n = 0; n < 2; ++n) cf[n] = *(const bf16x8*)(VnT + (wc * 32 + n * 16 + fr) * 136 + ks * 32 + fq * 8);
#pragma unroll
        for (int m = 0; m < 4; ++m)
#pragma unroll
            for (int n = 0; n < 2; ++n) acc[m][n] = __builtin_amdgcn_mfma_f32_16x16x32_bf16(cf[n], tf[m], acc[m][n], 0, 0, 0);
    }
#pragma unroll
    for (int m = 0; m < 4; ++m) {
        const int tl = wr * 64 + m * 16 + fr; const float bs = p.b_s[g * 128 + tl];
#pragma unroll
        for (int n = 0; n < 2; ++n) {
            bf16_t* up = p.U + (size_t)(row0 + tl) * 1024 + c0 + wc * 32 + n * 16 + 4 * fq;
            const u32x2 uu = *(const u32x2*)up;
            u32x2 o; o.x = pk2(bf_lo(uu.x) * (acc[m][n][0] + bs), bf_hi(uu.x) * (acc[m][n][1] + bs)); o.y = pk2(bf_lo(uu.y) * (acc[m][n][2] + bs), bf_hi(uu.y) * (acc[m][n][3] + bs));
            *(u32x2*)up = o;
        }
    }
    __syncthreads();
}

DI void idx_item(const Params& p, int b, int qi, unsigned char* smem) {
    const int tid = threadIdx.x, w = __builtin_amdgcn_readfirstlane(tid >> 6), lane = tid & 63, fr = lane & 15, fq = lane >> 4;
    const int t0 = qi * 16; const size_t rowb = (size_t)b * S_;
    unsigned* mbits = (unsigned*)smem; unsigned* ebits = mbits + 16 * 129;
    float* redf = (float*)(ebits + 16 * 129); int* cntb = (int*)(redf + 256);
    if (qi < 16) {
        for (int i = tid; i < 2048; i += 512) { const int q = i >> 7, wd = i & 127, t = t0 + q, lo = wd * 32;
            const unsigned mk = (t >= lo + 31) ? 0xffffffffu : (t < lo ? 0u : ((2u << (t - lo)) - 1u));
            p.mask[(rowb + t0 + q) * 128 + wd] = mk; }
        return;
    }
    const int nkt = qi + 1;
    const float NINF = -__builtin_inff();
    float sc[32][4];
#pragma unroll
    for (int hp = 0; hp < 2; ++hp) {
        bf16x8 qf[4][2]; const bf16_t* qrow = p.QI + (rowb + t0 + fr) * 512 + hp * 256 + fq * 8;
#pragma unroll
        for (int h = 0; h < 4; ++h) { qf[h][0] = *(const bf16x8*)(qrow + h * 64); qf[h][1] = *(const bf16x8*)(qrow + h * 64 + 32); }
        const f32x4 wv = *(const f32x4*)(p.WI + (rowb + t0 + fr) * 8 + hp * 4);
        const bf16_t* kbase = p.KIn + (rowb + fr) * 64 + fq * 8;
        bf16x8 kf0 = {0, 0, 0, 0, 0, 0, 0, 0}, kf1 = kf0, nf0 = kf0, nf1 = kf0;
        if (w < nkt) { kf0 = *(const bf16x8*)(kbase + (size_t)(16 * w) * 64); kf1 = *(const bf16x8*)(kbase + (size_t)(16 * w) * 64 + 32); }
#pragma unroll
        for (int r = 0; r < 32; ++r) {
            const int kt = w + 8 * r;
            if (kt < nkt) {
                if (kt + 8 < nkt) { nf0 = *(const bf16x8*)(kbase + (size_t)(16 * (kt + 8)) * 64); nf1 = *(const bf16x8*)(kbase + (size_t)(16 * (kt + 8)) * 64 + 32); }
                f32x4 s = {0.f, 0.f, 0.f, 0.f};
                if (hp == 1) {
#pragma unroll
                    for (int j = 0; j < 4; ++j) s[j] = sc[r][j];
                }
#pragma unroll
                for (int h = 0; h < 4; ++h) {
                    f32x4 a = __builtin_amdgcn_mfma_f32_16x16x32_bf16(kf0, qf[h][0], (f32x4){0.f, 0.f, 0.f, 0.f}, 0, 0, 0);
                    a = __builtin_amdgcn_mfma_f32_16x16x32_bf16(kf1, qf[h][1], a, 0, 0, 0);
#pragma unroll
                    for (int j = 0; j < 4; ++j) s[j] += wv[h] * fmaxf(a[j], 0.f);
                }
                if (hp == 1 && kt == nkt - 1) {
#pragma unroll
                    for (int j = 0; j < 4; ++j) if (4 * fq + j > fr) s[j] = NINF;
                }
#pragma unroll
                for (int j = 0; j < 4; ++j) sc[r][j] = s[j];
                kf0 = nf0; kf1 = nf1;
            } else {
#pragma unroll
                for (int j = 0; j < 4; ++j) sc[r][j] = NINF;
            }
        }
    }
    const int rmax = (nkt - 1) >> 3;
    float mn = __builtin_inff(), mx = NINF;
#pragma unroll
    for (int r = 0; r < 32; ++r)
#pragma unroll
        for (int j = 0; j < 4; ++j) { const float v = sc[r][j]; mx = fmaxf(mx, v); mn = fminf(mn, v == NINF ? __builtin_inff() : v); }
    mn = fminf(mn, __shfl_xor(mn, 16)); mn = fminf(mn, __shfl_xor(mn, 32)); mx = fmaxf(mx, __shfl_xor(mx, 16)); mx = fmaxf(mx, __shfl_xor(mx, 32));
    if (fq == 0) { redf[w * 16 + fr] = mn; redf[128 + w * 16 + fr] = mx; }
    for (int i = tid; i < 2 * 16 * 129; i += 512) mbits[i] = 0u;
    __syncthreads();
    float lo = redf[fr], mxa = redf[128 + fr];
#pragma unroll
    for (int w2 = 1; w2 < 8; ++w2) { lo = fminf(lo, redf[w2 * 16 + fr]); mxa = fmaxf(mxa, redf[128 + w2 * 16 + fr]); }
    float hi = mxa + fabsf(mxa) * 1e-3f + 1e-20f;
    int clo = t0 + fr + 1, chi = 0; bool done = false;
    for (int it = 0; it < 256; ++it) {
        const float mid = lo + 0.5f * (hi - lo);
        if (!(mid > lo && mid < hi)) done = true;
        if (__all(done)) break;
        int c = 0;
#pragma unroll
        for (int r4 = 0; r4 < 8; ++r4) {
            if (r4 * 4 <= rmax) {
#pragma unroll
                for (int rr = 0; rr < 4; ++rr)
#pragma unroll
                    for (int j = 0; j < 4; ++j) c += (sc[r4 * 4 + rr][j] >= mid) ? 1 : 0;
            }
        }
        c += __shfl_xor(c, 16); c += __shfl_xor(c, 32);
        if (fq == 0) cntb[(it & 1) * 128 + w * 16 + fr] = c;
        __syncthreads();
        int tot = 0;
#pragma unroll
        for (int w2 = 0; w2 < 8; ++w2) tot += cntb[(it & 1) * 128 + w2 * 16 + fr];
        if (!done) { if (tot >= 256) { lo = mid; clo = tot; if (tot == 256) done = true; } else { hi = mid; chi = tot; } }
    }
    const bool any_tie = __any(clo != 256);
#pragma unroll
    for (int r = 0; r < 32; ++r) {
        const int kt = w + 8 * r;
        if (kt < nkt) {
            unsigned nib = 0u, enib = 0u;
#pragma unroll
            for (int j = 0; j < 4; ++j) { const float v = sc[r][j]; const bool ge = v >= lo; nib |= (ge ? 1u : 0u) << j; enib |= ((ge && v < hi) ? 1u : 0u) << j; }
            const int word = kt >> 1, sh = (kt & 1) * 16 + fq * 4;
            if (nib) atomicOr(&mbits[fr * 129 + word], nib << sh);
            if (any_tie && enib) atomicOr(&ebits[fr * 129 + word], enib << sh);
        }
    }
    __syncthreads();
    if (any_tie && tid < 16) {
        int excess = clo - 256;
        for (int wd = 127; wd >= 0 && excess > 0; --wd) { unsigned e = ebits[tid * 129 + wd];
            while (e && excess > 0) { const int hb = 31 - __clz(e); e &= ~(1u << hb); mbits[tid * 129 + wd] &= ~(1u << hb); --excess; } }
    }
    __syncthreads();
    for (int i = tid; i < 2048; i += 512) { const int q = i >> 7, wd = i & 127; p.mask[(rowb + t0 + q) * 128 + wd] = mbits[q * 129 + wd]; }
    __syncthreads();
}

DI void phase_mix(const Params& p, unsigned char* smem) {
    const int G = gridDim.x, c = blockIdx.x;
    for (int r = 0; r * G < 1024; ++r) {
        const int j = r * G + ((r & 1) ? (G - 1 - c) : c);
        if (j < 1024) idx_item(p, j & 3, 255 - (j >> 2), smem);
    }
    for (int it = c; it < 1024; it += G) gmlp_item(p, it, smem);
}

DI void attn_item(const Params& p, int b, int g, int qb, unsigned char* smem) {
    const int tid = threadIdx.x, w = tid >> 6, lane = tid & 63, r32 = lane & 31, h = lane >> 5;
    const int hh = w & 3, qs = w >> 2, head = g * 4 + hh;
    const size_t rowb = (size_t)b * S_;
    const int trow = qb * 64 + qs * 32 + r32;
    bf16x8 qf[8];
    bf16_t* qp = p.Q + (rowb + trow) * 1024 + head * 128;
#pragma unroll
    for (int ks = 0; ks < 8; ++ks) qf[ks] = *(const bf16x8*)(qp + ks * 16 + h * 8);
    f32x16 o[4];
#pragma unroll
    for (int dt = 0; dt < 4; ++dt)
#pragma unroll
        for (int i = 0; i < 16; ++i) o[dt][i] = 0.f;
    float m_run = -1e30f, l_run = 0.f;
    const int nkt = qb + 1;
    unsigned char* Kt[2] = {smem, smem + 17408}; unsigned char* Vt[2] = {smem + 2 * 17408, smem + 3 * 17408};
    const int kr0 = tid >> 4, kc = tid & 15;
    const int vd0 = tid >> 3, vc = tid & 7;
    const bf16_t* kg = p.Kk + (rowb + kr0) * 256 + g * 128 + kc * 8;
    const bf16_t* vg = p.VT + ((size_t)(b * 256 + g * 128 + vd0)) * 4096 + vc * 8;
    const unsigned* mp = p.mask + (rowb + trow) * 128;
    u32x4 kreg[2], vreg[2];
    kreg[0] = *(const u32x4*)(kg); kreg[1] = *(const u32x4*)(kg + 32 * 256);
    vreg[0] = *(const u32x4*)(vg); vreg[1] = *(const u32x4*)(vg + (size_t)64 * 4096);
    *(u32x4*)(Kt[0] + kr0 * 272 + kc * 16) = kreg[0]; *(u32x4*)(Kt[0] + (kr0 + 32) * 272 + kc * 16) = kreg[1];
    *(u32x2*)(Vt[0] + vd0 * 136 + vc * 16) = (u32x2){vreg[0].x, vreg[0].y}; *(u32x2*)(Vt[0] + vd0 * 136 + vc * 16 + 8) = (u32x2){vreg[0].z, vreg[0].w};
    *(u32x2*)(Vt[0] + (vd0 + 64) * 136 + vc * 16) = (u32x2){vreg[1].x, vreg[1].y}; *(u32x2*)(Vt[0] + (vd0 + 64) * 136 + vc * 16 + 8) = (u32x2){vreg[1].z, vreg[1].w};
    __syncthreads();
    for (int kt = 0; kt < nkt; ++kt) {
        const int cur = kt & 1;
        const bool more = kt + 1 < nkt;
        if (more) {
            const bf16_t* kg2 = kg + (size_t)(kt + 1) * 64 * 256; const bf16_t* vg2 = vg + (kt + 1) * 64;
            kreg[0] = *(const u32x4*)(kg2); kreg[1] = *(const u32x4*)(kg2 + 32 * 256);
            vreg[0] = *(const u32x4*)(vg2); vreg[1] = *(const u32x4*)(vg2 + (size_t)64 * 4096);
        }
        const u32x2 mw = *(const u32x2*)(mp + 2 * kt);
        f32x16 s[2];
#pragma unroll
        for (int mt = 0; mt < 2; ++mt) {
#pragma unroll
            for (int i = 0; i < 16; ++i) s[mt][i] = 0.f;
#pragma unroll
            for (int ks = 0; ks < 8; ++ks) { const bf16x8 a = *(const bf16x8*)(Kt[cur] + (mt * 32 + r32) * 272 + ks * 32 + h * 16); s[mt] = __builtin_amdgcn_mfma_f32_32x32x16_bf16(a, qf[ks], s[mt], 0, 0, 0); }
        }
        float mx = -1e30f;
#pragma unroll
        for (int mt = 0; mt < 2; ++mt) { const unsigned wd = (mt == 0 ? mw.x : mw.y) >> (4 * h);
#pragma unroll
            for (int i = 0; i < 16; ++i) { const int bit = (i & 3) + 8 * (i >> 2); const bool on = (wd >> bit) & 1u; const float v = on ? s[mt][i] : -1e30f; s[mt][i] = v; mx = fmaxf(mx, v); } }
        mx = fmaxf(mx, __shfl_xor(mx, 32));
        const float m_new = fmaxf(m_run, mx); const float alpha = __builtin_amdgcn_exp2f(m_run - m_new); m_run = m_new;
        float ls = 0.f;
#pragma unroll
        for (int mt = 0; mt < 2; ++mt)
#pragma unroll
            for (int i = 0; i < 16; ++i) { const float v = s[mt][i]; const float pv = v > -1e29f ? __builtin_amdgcn_exp2f(v - m_new) : 0.f; s[mt][i] = pv; ls += pv; }
        l_run = l_run * alpha + ls;
#pragma unroll
        for (int dt = 0; dt < 4; ++dt)
#pragma unroll
            for (int i = 0; i < 16; ++i) o[dt][i] *= alpha;
#pragma unroll
        for (int mt = 0; mt < 2; ++mt)
#pragma unroll
            for (int s2 = 0; s2 < 2; ++s2) {
                u32x4 pw; pw.x = pk2(s[mt][8 * s2 + 0], s[mt][8 * s2 + 1]); pw.y = pk2(s[mt][8 * s2 + 2], s[mt][8 * s2 + 3]); pw.z = pk2(s[mt][8 * s2 + 4], s[mt][8 * s2 + 5]); pw.w = pk2(s[mt][8 * s2 + 6], s[mt][8 * s2 + 7]);
                const bf16x8 pf = __builtin_bit_cast(bf16x8, pw);
                const int kb = (32 * mt + 16 * s2 + 4 * h) * 2;
#pragma unroll
                for (int dt = 0; dt < 4; ++dt) {
                    const unsigned char* vp = Vt[cur] + (dt * 32 + r32) * 136 + kb;
                    const u32x2 v0 = *(const u32x2*)vp, v1 = *(const u32x2*)(vp + 16);
                    const u32x4 vv = {v0.x, v0.y, v1.x, v1.y};
                    o[dt] = __builtin_amdgcn_mfma_f32_32x32x16_bf16(__builtin_bit_cast(bf16x8, vv), pf, o[dt], 0, 0, 0);
                }
            }
        if (more) {
            unsigned char* kd = Kt[cur ^ 1]; unsigned char* vd = Vt[cur ^ 1];
            *(u32x4*)(kd + kr0 * 272 + kc * 16) = kreg[0]; *(u32x4*)(kd + (kr0 + 32) * 272 + kc * 16) = kreg[1];
            *(u32x2*)(vd + vd0 * 136 + vc * 16) = (u32x2){vreg[0].x, vreg[0].y}; *(u32x2*)(vd + vd0 * 136 + vc * 16 + 8) = (u32x2){vreg[0].z, vreg[0].w};
            *(u32x2*)(vd + (vd0 + 64) * 136 + vc * 16) = (u32x2){vreg[1].x, vreg[1].y}; *(u32x2*)(vd + (vd0 + 64) * 136 + vc * 16 + 8) = (u32x2){vreg[1].z, vreg[1].w};
        }
        __syncthreads();
    }
    const float lt = l_run + __shfl_xor(l_run, 32);
    const float inv = 1.0f / lt;
#pragma unroll
    for (int dt = 0; dt < 4; ++dt)
#pragma unroll
        for (int i4 = 0; i4 < 4; ++i4) {
            u32x2 ov; ov.x = pk2(o[dt][4 * i4 + 0] * inv, o[dt][4 * i4 + 1] * inv); ov.y = pk2(o[dt][4 * i4 + 2] * inv, o[dt][4 * i4 + 3] * inv);
            *(u32x2*)(qp + dt * 32 + 8 * i4 + 4 * h) = ov;
        }
}

DI void phase_attn(const Params& p, unsigned char* smem) {
    const int G = gridDim.x, c = blockIdx.x;
    for (int r = 0; r * G < 512; ++r) {
        const int j = r * G + ((r & 1) ? (G - 1 - c) : c);
        if (j < 512) attn_item(p, (j & 7) >> 1, j & 1, 63 - (j >> 3), smem);
    }
}

DI void run_phase(const Params& p, int ph, unsigned char* smem) {
    switch (ph) {
        case 0: phase0(p, smem); break;
        case 1: rownorm_phase<0>(p); break;
        case 2: { EpiIn E{p}; run_gemm(smem, p.H, p.WtIn, T_, 6400, 1024, E); } break;
        case 3: phase_mix(p, smem); break;
        case 4: phase_attn(p, smem); break;
        case 5: { EpiMergeA Ea{p.GA}; run_gemm(smem, p.U, p.WtPa, T_, 1024, 1024, Ea);
                  EpiMergeB Eb{p.GA, p.GB, p.Mg}; run_gemm(smem, p.Q, p.WtPb, T_, 1024, 1024, Eb); } break;
        case 6: { EpiRes E{p.x, p.mod + 2048, p.out}; run_gemm(smem, p.Mg, p.WtOut, T_, 1024, 1024, E); } break;
        case 7: rownorm_phase<1>(p); break;
        case 8: { EpiF1 E{p.Hff}; run_gemm(smem, p.H, p.WtF1, T_, 2 * DFF_, 1024, E); } break;
        case 9: { EpiRes E{p.out, p.mod + 5120, p.out}; run_gemm(smem, p.Hff, p.WtF2, T_, 1024, DFF_, E); } break;
        case 10: rownorm_phase<2>(p); break;
        default: break;
    }
}
constexpr int NPHASE = 11;

#if !MULTI_LAUNCH
template <bool COOP> __global__ __launch_bounds__(512, 2) void mega(Params p, int ph_lo, int ph_hi) {
    extern __shared__ __attribute__((aligned(16))) unsigned char smem[];
    for (int ph = ph_lo; ph <= ph_hi; ++ph) {
        run_phase(p, ph, smem);
        if (COOP && ph < ph_hi) cg::this_grid().sync();
    }
}

#endif
template <int PH> __global__ __launch_bounds__(512, 2) void phase_k(Params p) {
    extern __shared__ __attribute__((aligned(16))) unsigned char smem[];
    run_phase(p, PH, smem);
}
template <int PH> static void launch_phase(const Params& p, hipStream_t stream) {
    (void)hipFuncSetAttribute((const void*)phase_k<PH>, hipFuncAttributeMaxDynamicSharedMemorySize, 131072);
    phase_k<PH><<<dim3(256), dim3(512), 131072, stream>>>(p);
}

extern "C" void kernel_launch(void* const* d_in, const int* in_sizes, int n_in, void* d_out, int out_size, void* d_ws, size_t ws_size, hipStream_t stream) {
    (void)in_sizes; (void)n_in; (void)out_size; (void)ws_size;
    Params p; memset(&p, 0, sizeof(p));
    p.x = (const float*)d_in[0]; p.c = (const float*)d_in[1]; p.pos = (const int*)d_in[2];
    p.w_ada = (const float*)d_in[3]; p.b_ada = (const float*)d_in[4]; p.norm1_g = (const float*)d_in[5]; p.w_in = (const float*)d_in[6];
    p.ln_g = (const float*)d_in[7]; p.ln_b = (const float*)d_in[8]; p.w_s = (const float*)d_in[9]; p.b_s = (const float*)d_in[10];
    p.kln_g = (const float*)d_in[11]; p.kln_b = (const float*)d_in[12]; p.w_pa = (const float*)d_in[13]; p.w_pb = (const float*)d_in[14]; p.w_out = (const float*)d_in[15];
    p.norm2_g = (const float*)d_in[16]; p.w_f1 = (const float*)d_in[17]; p.w_f2 = (const float*)d_in[18]; p.fin_g = (const float*)d_in[19];
    p.out = (float*)d_out;
    unsigned char* ws = (unsigned char*)d_ws; size_t off = 0;
    auto take = [&](size_t bytes) { unsigned char* r = ws + off; off += (bytes + 255) & ~(size_t)255; return r; };
    p.WtIn = (bf16_t*)take((size_t)6400 * 1024 * 2); p.WtPa = (bf16_t*)take((size_t)1024 * 1024 * 2); p.WtPb = (bf16_t*)take((size_t)1024 * 1024 * 2); p.WtOut = (bf16_t*)take((size_t)1024 * 1024 * 2);
    p.WtF1 = (bf16_t*)take((size_t)2 * DFF_ * 1024 * 2); p.WtF2 = (bf16_t*)take((size_t)1024 * DFF_ * 2);
    p.mod = (float*)take((size_t)4 * 6144 * 4); p.rope = (float*)take((size_t)T_ * 48 * 4);
    p.Kk = (bf16_t*)take((size_t)T_ * 256 * 2); p.VT = (bf16_t*)take((size_t)T_ * 256 * 2); p.QI = (bf16_t*)take((size_t)T_ * 512 * 2); p.KIn = (bf16_t*)take((size_t)T_ * 64 * 2);
    p.WI = (float*)take((size_t)T_ * 8 * 4); p.stats = (float*)take((size_t)T_ * 16 * 2 * 4);
    p.H = (bf16_t*)take((size_t)T_ * 1024 * 2);
    p.mask = (unsigned*)p.H;
    p.Mg = p.H;
    p.U = (bf16_t*)take((size_t)T_ * 1024 * 2); p.Vg = (bf16_t*)take((size_t)T_ * 1024 * 2); p.Q = (bf16_t*)take((size_t)T_ * 1024 * 2);
    p.Hff = p.U;
    p.GA = (bf16_t*)d_out; p.GB = (bf16_t*)d_out + (size_t)T_ * 1024;

#if MULTI_LAUNCH
    launch_phase<0>(p, stream); launch_phase<1>(p, stream); launch_phase<2>(p, stream); launch_phase<3>(p, stream); launch_phase<4>(p, stream); launch_phase<5>(p, stream);
    launch_phase<6>(p, stream); launch_phase<7>(p, stream); launch_phase<8>(p, stream); launch_phase<9>(p, stream); launch_phase<10>(p, stream);
#else
    static bool attr_done = false;
    if (!attr_done) { (void)hipFuncSetAttribute((const void*)mega<true>, hipFuncAttributeMaxDynamicSharedMemorySize, 131072); attr_done = true; }
    static int grid_blocks = 0;
    if (!grid_blocks) { int dev = 0, cus = 0, per_cu = 0; hipGetDevice(&dev); hipDeviceGetAttribute(&cus, hipDeviceAttributeMultiprocessorCount, dev);
        hipOccupancyMaxActiveBlocksPerMultiprocessor(&per_cu, mega<true>, 512, 131072); if (per_cu < 1) per_cu = 1; if (per_cu > 1) per_cu = 1; grid_blocks = cus * per_cu; }
    int lo = 0, hi = NPHASE - 1; void* args[] = {&p, &lo, &hi};
    hipError_t e = hipLaunchCooperativeKernel((const void*)mega<true>, dim3(grid_blocks), dim3(512), args, 131072, stream);
    if (e != hipSuccess) fprintf(stderr, "cooperative launch failed: %s (grid %d)\n", hipGetErrorString(e), grid_blocks);
#endif
}
```
